# Optimizing an MI355X kernel written in HIP

```python
import jax, jax.numpy as jnp
from jax import lax
import numpy as np

D_MODEL = 1024
BATCH = 4
SEQ = 8192
DEPTH = 1

N_MEM = 256
HEAD_DIM = 64
N_ATTN_HEADS = 8
N_MEM_HEADS = 4
POOL_WINDOWS = (2, 4, 8, 16)
N_POOL_GROUPS = 4
POOL_GROUP_DIM = 64
D_ATTN = N_ATTN_HEADS * HEAD_DIM
D_POOL = N_POOL_GROUPS * POOL_GROUP_DIM
D_XMEM = N_MEM_HEADS * HEAD_DIM
D_MIX = D_ATTN + D_POOL + D_XMEM
D_IN = 3 * D_ATTN + D_POOL + D_XMEM
DILATED = ((128, 1), (512, 4), (2048, 16))
BLK = 128
D_FF = 4 * D_MODEL
EPS = 1e-6

kernel_name = 'hymba_dilated_pool_memory_layer'


def rmsnorm(x, g):
    xf = x.astype(jnp.float32)
    xf = xf * lax.rsqrt(jnp.mean(xf * xf, axis=-1, keepdims=True) + EPS)
    return xf.astype(x.dtype) * g


def alibi_slopes(n_heads):
    return 2.0 ** (-8.0 * jnp.arange(1, n_heads + 1, dtype=jnp.float32) / n_heads)


def band_blocks(t, n_prev, nb):
    N, H, _, Dh = t.shape
    tp = jnp.pad(t, ((0, 0), (0, 0), (n_prev * BLK, 0), (0, 0)))
    tb = tp.reshape(N, H, nb + n_prev, BLK, Dh)
    return jnp.concatenate([tb[:, :, o:o + nb] for o in range(n_prev + 1)], axis=3)


def dilated_window_attention(q, k, v, window, dilation, slopes):
    B, S, H, Dh = q.shape
    L = S // dilation
    Lp = -(-L // BLK) * BLK
    nb = Lp // BLK
    span = window // dilation
    n_prev = -(-span // BLK)
    N = B * dilation

    def to_sub(t):
        t = t.reshape(B, L, dilation, H, Dh).transpose(0, 2, 3, 1, 4).reshape(N, H, L, Dh)
        return jnp.pad(t, ((0, 0), (0, 0), (0, Lp - L), (0, 0)))

    qb = to_sub(q).reshape(N, H, nb, BLK, Dh)
    kb = band_blocks(to_sub(k), n_prev, nb)
    vb = band_blocks(to_sub(v), n_prev, nb)
    KB = (n_prev + 1) * BLK
    s = jnp.einsum('nhbqd,nhbkd->nhbqk', qb, kb).astype(jnp.float32) * (Dh ** -0.5)
    qi = jnp.arange(BLK)[:, None]
    ki = jnp.arange(KB)[None, :]
    rel = n_prev * BLK + qi - ki
    key_idx = (jnp.arange(nb)[:, None, None] - n_prev) * BLK + ki[None]
    valid = (rel >= 0) & (rel <= span) & (key_idx >= 0)
    bias = -slopes[:, None, None, None] * (dilation * rel).astype(jnp.float32)
    s = jnp.where(valid, s + bias, -jnp.inf)
    m = jnp.max(s, axis=-1, keepdims=True)
    p = jnp.exp(s - m)
    den = jnp.sum(p, axis=-1, keepdims=True)
    o = jnp.einsum('nhbqk,nhbkd->nhbqd', (p / den).astype(v.dtype), vb)
    lse = (m + jnp.log(den))[..., 0]
    o = o.reshape(N, H, Lp, Dh)[:, :, :L].reshape(B, dilation, H, L, Dh)
    o = o.transpose(0, 3, 1, 2, 4).reshape(B, S, H, Dh)
    lse = lse.reshape(N, H, Lp)[:, :, :L].reshape(B, dilation, H, L)
    lse = lse.transpose(0, 3, 1, 2).reshape(B, S, H)
    return o, lse


def causal_multiscale_pool(u):
    B, S, _ = u.shape
    ug = u.astype(jnp.float32).reshape(B, S, N_POOL_GROUPS, POOL_GROUP_DIM)
    cs = jnp.pad(jnp.cumsum(ug, axis=1), ((0, 0), (1, 0), (0, 0), (0, 0)))
    t = jnp.arange(S)
    outs = []
    for g, w in enumerate(POOL_WINDOWS):
        lo = jnp.maximum(t + 1 - w, 0)
        total = cs[:, 1:, g] - cs[:, lo, g]
        cnt = (t + 1 - lo).astype(jnp.float32)
        outs.append(total / cnt[None, :, None])
    pooled = jnp.stack(outs, axis=2)
    return (pooled - ug).astype(u.dtype)


def setup_inputs(seed: int = 0) -> dict:
    key = jax.random.key(seed)
    ks = jax.random.split(key, 13)

    def nrm(k, shape, fan_in):
        return jax.random.normal(k, shape, jnp.float32) * (fan_in ** -0.5)

    def gain(k, shape):
        return 1.0 + 0.1 * jax.random.normal(k, shape, jnp.float32)

    return {
        'x': jax.random.normal(ks[0], (BATCH, SEQ, D_MODEL), jnp.float32),
        'mem': jax.random.normal(ks[1], (BATCH, N_MEM, D_MODEL), jnp.float32),
        'g_mix': gain(ks[2], (DEPTH, D_MODEL)),
        'w_in': nrm(ks[3], (DEPTH, D_MODEL, D_IN), D_MODEL),
        'g_mem': gain(ks[4], (DEPTH, D_MODEL)),
        'w_mem_kv': nrm(ks[5], (DEPTH, D_MODEL, 2 * D_XMEM), D_MODEL),
        'w_pool': nrm(ks[6], (DEPTH, N_POOL_GROUPS, POOL_GROUP_DIM, POOL_GROUP_DIM), POOL_GROUP_DIM),
        'pool_scale': gain(ks[7], (DEPTH, D_POOL)),
        'w_out': nrm(ks[8], (DEPTH, D_MIX, D_MODEL), D_MIX),
        'g_ffn': gain(ks[9], (DEPTH, D_MODEL)),
        'w_ff1': nrm(ks[10], (DEPTH, D_MODEL, D_FF), D_MODEL),
        'w_ff2': nrm(ks[11], (DEPTH, D_FF, D_MODEL), D_FF),
        'g_final': gain(ks[12], (D_MODEL,)),
    }


def reference(x, mem, g_mix, w_in, g_mem, w_mem_kv, w_pool, pool_scale, w_out,
              g_ffn, w_ff1, w_ff2, g_final):
    B, S, _ = x.shape
    slopes = alibi_slopes(N_ATTN_HEADS)
    for i in range(DEPTH):
        h = rmsnorm(x, g_mix[i])
        proj = h @ w_in[i]
        q, k, v, u, qm = jnp.split(
            proj, [D_ATTN, 2 * D_ATTN, 3 * D_ATTN, 3 * D_ATTN + D_POOL], axis=-1)
        q = q.reshape(B, S, N_ATTN_HEADS, HEAD_DIM)
        k = k.reshape(B, S, N_ATTN_HEADS, HEAD_DIM)
        v = v.reshape(B, S, N_ATTN_HEADS, HEAD_DIM)

        outs, lses = [], []
        for window, dilation in DILATED:
            o, l = dilated_window_attention(q, k, v, window, dilation, slopes)
            outs.append(o)
            lses.append(l)
        wts = jax.nn.softmax(jnp.stack(lses, axis=0), axis=0)
        y_attn = jnp.sum(wts[..., None] * jnp.stack(outs, axis=0).astype(jnp.float32), axis=0)
        y_attn = y_attn.astype(x.dtype).reshape(B, S, D_ATTN)

        d = causal_multiscale_pool(u)
        y_pool = jnp.einsum('bsgc,gce->bsge', d, w_pool[i]).reshape(B, S, D_POOL) * pool_scale[i]

        mn = rmsnorm(mem, g_mem[i])
        km, vm = jnp.split(mn @ w_mem_kv[i], 2, axis=-1)
        km = km.reshape(B, N_MEM, N_MEM_HEADS, HEAD_DIM)
        vm = vm.reshape(B, N_MEM, N_MEM_HEADS, HEAD_DIM)
        qm = qm.reshape(B, S, N_MEM_HEADS, HEAD_DIM)
        sm = jnp.einsum('bshd,bmhd->bhsm', qm, km).astype(jnp.float32) * (HEAD_DIM ** -0.5)
        pm = jax.nn.softmax(sm, axis=-1).astype(vm.dtype)
        y_mem = jnp.einsum('bhsm,bmhd->bshd', pm, vm).reshape(B, S, D_XMEM)

        y = jnp.concatenate([y_attn, y_pool, y_mem], axis=-1)
        x = x + y @ w_out[i]

        h2 = rmsnorm(x, g_ffn[i])
        a = jax.nn.relu(h2 @ w_ff1[i])
        x = x + (a * a) @ w_ff2[i]
    return rmsnorm(x, g_final)
```

```cpp
#include <hip/hip_runtime.h>
#include <cstdio>
#include <cstdint>
namespace pg8 {
#define PG8_LAS __attribute__((address_space(3)))
typedef unsigned short bf16_t;
typedef short bf16x8 __attribute__((ext_vector_type(8)));
typedef float f32x4 __attribute__((ext_vector_type(4)));
typedef unsigned u32x4 __attribute__((ext_vector_type(4)));
constexpr int BM = 256, BK = 64, HALF = 128, HTB = HALF * BK * 2  , STAGE_BYTES = 8 * HTB, NXCD = 8, WGM = 8;

__host__ __device__ __forceinline__ int lds_byte(int r, int c) { const int st = (r >> 4) * 2 + (c >> 5), rr = r & 15, cc = c & 31, ob = rr * 64 + cc * 2; return st * 1024 + (ob ^ (((ob >> 9) & 1) << 5)); }
__host__ __device__ __forceinline__ void stage_rc(int b, int& R, int& C) { const int st = b / 1024, sb = b % 1024, swz = sb ^ (((sb >> 9) & 1) << 5); R = (st >> 1) * 16 + swz / 64; C = (st & 1) * 32 + (swz % 64) / 2; }
__host__ __device__ __forceinline__ int perm32(int rho) { const int n = rho >> 4, i = rho & 15; return 8 * (i >> 2) + 4 * n + (i & 3); }

struct Unit { int pm, pn; };
struct Gemm { const bf16_t* A; const bf16_t* Bt; int M, N, K; };

struct StaticOrder {
    int nM, nN, nwg, G, c;
    __host__ __device__ void init(int M, int N, int G_, int c_) { nM = M / BM; nN = N / BM; nwg = nM * nN; G = G_; c = c_; }
    __host__ __device__ bool next(int i, Unit& u) const {
        const long L = (long)i * G + c; if (L >= nwg) return false;
        int wgid = (int)L; { const int q = nwg / NXCD, r = nwg % NXCD, xcd = wgid % NXCD, off = wgid / NXCD; wgid = (xcd < r ? xcd * (q + 1) : r * (q + 1) + (xcd - r) * q) + off; }
        const int nig = WGM * nN, gid = wgid / nig, fm = gid * WGM, gsz = (nM - fm) < WGM ? (nM - fm) : WGM;
        u.pm = fm + ((wgid % nig) % gsz); u.pn = (wgid % nig) / gsz; return true;
    }
    __device__ __forceinline__ void a_ready(const Unit&) const {}
    __device__ __forceinline__ void done(const Unit&) const {}
};

__device__ __forceinline__ unsigned cvt_pk_bf16(float lo, float hi) { unsigned r; asm volatile("v_cvt_pk_bf16_f32 %0, %1, %2" : "=v"(r) : "v"(lo), "v"(hi)); return r; }
typedef float f32x2 __attribute__((ext_vector_type(2)));

struct EpiProj {
    static constexpr bool PERM = true, AFTER_DRAIN = false;
    bf16_t* O; int ldc; unsigned scale_mask; float scale0;
    __device__ __forceinline__ void operator()(const f32x4 (&acc)[2][2][4][2], const Unit& u, int wr, int wc, int fr, int fq) const {
        const int row0 = u.pm * BM + wr * 64 + fr; const int col0 = u.pn * BM + wc * 32 + 8 * fq;
        const float sc = ((scale_mask >> u.pn) & 1u) ? scale0 : 1.f;
#pragma unroll
        for (int ai = 0; ai < 2; ++ai)
#pragma unroll
            for (int m = 0; m < 4; ++m) { bf16_t* rowp = O + (size_t)(row0 + ai * HALF + m * 16) * ldc + col0;
#pragma unroll
                for (int bj = 0; bj < 2; ++bj) { const f32x4 v0 = acc[ai][bj][m][0] * sc, v1 = acc[ai][bj][m][1] * sc;
                    u32x4 w; w.x = cvt_pk_bf16(v0[0], v0[1]); w.y = cvt_pk_bf16(v0[2], v0[3]); w.z = cvt_pk_bf16(v1[0], v1[1]); w.w = cvt_pk_bf16(v1[2], v1[3]);
                    *(u32x4*)(rowp + bj * HALF) = w; } }
    }
};

struct EpiResSS {
    static constexpr bool PERM = true, AFTER_DRAIN = false;
    const float* base; bf16_t* xb; float* ss; int ldc;
    __device__ __forceinline__ void operator()(const f32x4 (&acc)[2][2][4][2], const Unit& u, int wr, int wc, int fr, int fq) const {
        const int row0 = u.pm * BM + wr * 64 + fr; const int col0 = u.pn * BM + wc * 32 + 8 * fq;
#pragma unroll
        for (int ai = 0; ai < 2; ++ai)
#pragma unroll
            for (int m = 0; m < 4; ++m) { const int row = row0 + ai * HALF + m * 16; const size_t off = (size_t)row * ldc + col0; float s = 0.f;
#pragma unroll
                for (int bj = 0; bj < 2; ++bj) {
                    const f32x4 b0 = *(const f32x4*)(base + off + bj * HALF), b1 = *(const f32x4*)(base + off + bj * HALF + 4);
                    const f32x4 v0 = acc[ai][bj][m][0] + b0, v1 = acc[ai][bj][m][1] + b1;
                    u32x4 w; w.x = cvt_pk_bf16(v0[0], v0[1]); w.y = cvt_pk_bf16(v0[2], v0[3]); w.z = cvt_pk_bf16(v1[0], v1[1]); w.w = cvt_pk_bf16(v1[2], v1[3]);
                    *(u32x4*)(xb + off + bj * HALF) = w;
                    s += (v0[0] * v0[0] + v0[1] * v0[1]) + (v0[2] * v0[2] + v0[3] * v0[3]) + (v1[0] * v1[0] + v1[1] * v1[1]) + (v1[2] * v1[2] + v1[3] * v1[3]); }
                s += __shfl_xor(s, 16); s += __shfl_xor(s, 32);
                if (fq == 0) ss[(size_t)row * 16 + u.pn * 4 + wc] = s;
                if (m & 1) asm volatile("" ::: "memory"); }
    }
};

struct EpiRelu2 {
    static constexpr bool PERM = true, AFTER_DRAIN = false;
    bf16_t* O; int ldc;
    __device__ __forceinline__ void operator()(const f32x4 (&acc)[2][2][4][2], const Unit& u, int wr, int wc, int fr, int fq) const {
        const int row0 = u.pm * BM + wr * 64 + fr; const int col0 = u.pn * BM + wc * 32 + 8 * fq;
#pragma unroll
        for (int ai = 0; ai < 2; ++ai)
#pragma unroll
            for (int m = 0; m < 4; ++m) { bf16_t* rowp = O + (size_t)(row0 + ai * HALF + m * 16) * ldc + col0;
#pragma unroll
                for (int bj = 0; bj < 2; ++bj) { f32x4 v0 = acc[ai][bj][m][0], v1 = acc[ai][bj][m][1];
#pragma unroll
                    for (int e = 0; e < 4; ++e) { const float p = fmaxf(v0[e], 0.f), q = fmaxf(v1[e], 0.f); v0[e] = p * p; v1[e] = q * q; }
                    u32x4 w; w.x = cvt_pk_bf16(v0[0], v0[1]); w.y = cvt_pk_bf16(v0[2], v0[3]); w.z = cvt_pk_bf16(v1[0], v1[1]); w.w = cvt_pk_bf16(v1[2], v1[3]);
                    *(u32x4*)(rowp + bj * HALF) = w; } }
    }
};

struct EpiRes2 {
    static constexpr bool PERM = true, AFTER_DRAIN = false;
    bf16_t* xb; const float* ss; float* ss2; int ldc; float inv_n, eps;
    __device__ __forceinline__ void operator()(const f32x4 (&acc)[2][2][4][2], const Unit& u, int wr, int wc, int fr, int fq) const {
        const int row0 = u.pm * BM + wr * 64 + fr; const int col0 = u.pn * BM + wc * 32 + 8 * fq;
#pragma unroll
        for (int ai = 0; ai < 2; ++ai) {
            float r2[4];
#pragma unroll
            for (int m = 0; m < 4; ++m) { const float* sp = ss + (size_t)(row0 + ai * HALF + m * 16) * 16;
                const f32x4 a = *(const f32x4*)(sp), b = *(const f32x4*)(sp + 4), c = *(const f32x4*)(sp + 8), d = *(const f32x4*)(sp + 12);
                const float t = ((a[0] + a[1]) + (a[2] + a[3])) + ((b[0] + b[1]) + (b[2] + b[3])) + ((c[0] + c[1]) + (c[2] + c[3])) + ((d[0] + d[1]) + (d[2] + d[3]));
                r2[m] = 1.0f / (t * inv_n + eps); }
#pragma unroll
            for (int m = 0; m < 4; ++m) { const int row = row0 + ai * HALF + m * 16; const size_t off = (size_t)row * ldc + col0; const float rr = r2[m]; float s = 0.f;
#pragma unroll
                for (int bj = 0; bj < 2; ++bj) { const u32x4 xo = *(const u32x4*)(xb + off + bj * HALF);
                    f32x4 v0 = acc[ai][bj][m][0] * rr, v1 = acc[ai][bj][m][1] * rr;
                    v0[0] += __uint_as_float(xo.x << 16); v0[1] += __uint_as_float(xo.x & 0xffff0000u); v0[2] += __uint_as_float(xo.y << 16); v0[3] += __uint_as_float(xo.y & 0xffff0000u);
                    v1[0] += __uint_as_float(xo.z << 16); v1[1] += __uint_as_float(xo.z & 0xffff0000u); v1[2] += __uint_as_float(xo.w << 16); v1[3] += __uint_as_float(xo.w & 0xffff0000u);
                    u32x4 w; w.x = cvt_pk_bf16(v0[0], v0[1]); w.y = cvt_pk_bf16(v0[2], v0[3]); w.z = cvt_pk_bf16(v1[0], v1[1]); w.w = cvt_pk_bf16(v1[2], v1[3]);
                    *(u32x4*)(xb + off + bj * HALF) = w;
                    s += (v0[0] * v0[0] + v0[1] * v0[1]) + (v0[2] * v0[2] + v0[3] * v0[3]) + (v1[0] * v1[0] + v1[1] * v1[1]) + (v1[2] * v1[2] + v1[3] * v1[3]); }
                s += __shfl_xor(s, 16); s += __shfl_xor(s, 32);
                if (fq == 0) ss2[(size_t)row * 16 + u.pn * 4 + wc] = s; } }
    }
};

template <class Epi, class Sched, bool ALIGN_EPI = false, bool SP2 = false>
__device__ __forceinline__ void gemm_phase(PG8_LAS unsigned char* lds, const Gemm g, const Sched& S, const Epi& E) {
    const int tid = threadIdx.x, wid = __builtin_amdgcn_readfirstlane(tid >> 6), lane = tid & 63, wr = wid >> 2, wc = wid & 3, fr = lane & 15, fq = lane >> 4;
    const int K = g.K, nt = K / BK;
    unsigned voffA[2], voffB[2];
#pragma unroll
    for (int i = 0; i < 2; ++i) { int R, C; stage_rc(tid * 16 + i * 8192, R, C); const int Rb = Epi::PERM ? ((R & ~31) + perm32(R & 31)) : R;
        voffA[i] = (unsigned)(R * K + C) * 2u; voffB[i] = (unsigned)(Rb * K + C) * 2u; }
    const size_t kstep = (size_t)(BK * 2);
    const size_t hstep = (size_t)HALF * K * 2;
    const size_t tstep = 2 * hstep;
    const unsigned ldsw = (unsigned)wid * 1024u;
    const int aoff = lds_byte(wr * 64 + fr, fq * 8), boff = lds_byte(wc * 32 + fr, fq * 8);
#define PG8_SA(b, h) (((b) * 2 + (h)) * HTB)
#define PG8_SB(b, h) ((4 + (b) * 2 + (h)) * HTB)
#define PG8_STAGE(bufoff, gbase, voff) do { _Pragma("unroll") for (int _i = 0; _i < 2; ++_i) \
        __builtin_amdgcn_global_load_lds((const unsigned*)((const char*)(gbase) + (voff)[_i]), (PG8_LAS unsigned*)(lds + (bufoff) + ldsw + _i * 8192), 16, 0, 0); } while (0)
#define PG8_LDA(dst, b, h) do { _Pragma("unroll") for (int m = 0; m < 4; ++m) _Pragma("unroll") for (int k = 0; k < 2; ++k) dst[m][k] = *(const PG8_LAS bf16x8*)(lds + PG8_SA(b, h) + aoff + m * 2048 + k * 1024); } while (0)
#define PG8_LDB(dst, b, h) do { _Pragma("unroll") for (int n = 0; n < 2; ++n) _Pragma("unroll") for (int k = 0; k < 2; ++k) dst[n][k] = *(const PG8_LAS bf16x8*)(lds + PG8_SB(b, h) + boff + n * 2048 + k * 1024); } while (0)
#define PG8_MMA(ai, bj, At, Bt) do { __builtin_amdgcn_s_setprio(1); _Pragma("unroll") for (int m = 0; m < 4; ++m) _Pragma("unroll") for (int n = 0; n < 2; ++n) _Pragma("unroll") for (int k = 0; k < 2; ++k) \
        acc[ai][bj][m][n] = __builtin_amdgcn_mfma_f32_16x16x32_bf16(Bt[n][k], At[m][k], acc[ai][bj][m][n], 0, 0, 0); __builtin_amdgcn_s_setprio(0); } while (0)
#define PG8_WAIT_V(n) asm volatile("s_waitcnt vmcnt(" #n ")" ::: "memory")
#define PG8_WAIT_L(n) asm volatile("s_waitcnt lgkmcnt(" #n ")" ::: "memory")
#define PG8_BAR __builtin_amdgcn_s_barrier()
#define PG8_SCHED __builtin_amdgcn_sched_barrier(0)
    Unit cur, nxt; int ui = 0;
    if (!S.next(0, cur)) return;
    f32x4 acc[2][2][4][2];
#pragma unroll
    for (int a = 0; a < 2; ++a)
#pragma unroll
        for (int b = 0; b < 2; ++b)
#pragma unroll
            for (int m = 0; m < 4; ++m)
#pragma unroll
                for (int n = 0; n < 2; ++n) acc[a][b][m][n] = (f32x4){0.f, 0.f, 0.f, 0.f};
    bf16x8 At[4][2], B0[2][2], B1[2][2];
    const char* cA = (const char*)g.A + (size_t)cur.pm * tstep; const char* cB = (const char*)g.Bt + (size_t)cur.pn * tstep;
    S.a_ready(cur);
    if constexpr (SP2) {
        PG8_STAGE(PG8_SB(0, 0), cB, voffB); PG8_STAGE(PG8_SB(0, 1), cB + hstep, voffB); PG8_STAGE(PG8_SA(0, 0), cA, voffA); PG8_STAGE(PG8_SA(0, 1), cA + hstep, voffA);
        if (wr == 1) PG8_BAR;
        PG8_WAIT_V(2); PG8_BAR;
        PG8_STAGE(PG8_SB(1, 0), cB + kstep, voffB); PG8_STAGE(PG8_SA(1, 0), cA + kstep, voffA); PG8_STAGE(PG8_SB(1, 1), cB + hstep + kstep, voffB);
        PG8_WAIT_V(6); PG8_BAR;
    } else {
        PG8_STAGE(PG8_SB(0, 0), cB, voffB); PG8_STAGE(PG8_SA(0, 0), cA, voffA); PG8_STAGE(PG8_SB(0, 1), cB + hstep, voffB); PG8_STAGE(PG8_SA(0, 1), cA + hstep, voffA);
        if (wr == 1) PG8_BAR;
        PG8_WAIT_V(4); PG8_BAR;
        PG8_STAGE(PG8_SB(1, 0), cB + kstep, voffB); PG8_STAGE(PG8_SA(1, 0), cA + kstep, voffA); PG8_STAGE(PG8_SB(1, 1), cB + hstep + kstep, voffB);
        PG8_WAIT_V(6); PG8_BAR;
    }
    for (;;) {
        const bool has_next = S.next(ui + 1, nxt);
        const char* nA = has_next ? (const char*)g.A + (size_t)nxt.pm * tstep : cA; const char* nB = has_next ? (const char*)g.Bt + (size_t)nxt.pn * tstep : cB;
        for (int t = 0; t < nt; t += 2) {
            const bool last = (t == nt - 2);
            const char* a1 = cA + (size_t)(t + 1) * kstep;
            const char* a2 = last ? nA : cA + (size_t)(t + 2) * kstep; const char* b2 = last ? nB : cB + (size_t)(t + 2) * kstep;
            const char* a3 = a2 + kstep; const char* b3 = b2 + kstep;
            if (last && has_next) S.a_ready(nxt);
            if constexpr (SP2) {
            PG8_LDB(B0, 0, 0); PG8_LDB(B1, 0, 1); PG8_SCHED; PG8_LDA(At, 0, 0); PG8_STAGE(PG8_SA(1, 1), a1 + hstep, voffA);
            PG8_WAIT_V(8); PG8_WAIT_L(0); PG8_BAR; PG8_MMA(0, 0, At, B0); PG8_MMA(0, 1, At, B1); PG8_BAR; PG8_SCHED;
            PG8_LDA(At, 0, 1); PG8_STAGE(PG8_SB(0, 0), b2, voffB); PG8_STAGE(PG8_SB(0, 1), b2 + hstep, voffB); PG8_STAGE(PG8_SA(0, 0), a2, voffA);
            PG8_WAIT_V(8); PG8_WAIT_L(0); PG8_BAR; PG8_MMA(1, 0, At, B0); PG8_MMA(1, 1, At, B1); PG8_BAR; PG8_SCHED;
            PG8_LDB(B0, 1, 0); PG8_LDB(B1, 1, 1); PG8_SCHED; PG8_LDA(At, 1, 0); PG8_STAGE(PG8_SA(0, 1), a2 + hstep, voffA);
            PG8_WAIT_V(8); PG8_WAIT_L(0); PG8_BAR; PG8_MMA(0, 0, At, B0); PG8_MMA(0, 1, At, B1); PG8_BAR; PG8_SCHED;
            PG8_LDA(At, 1, 1); PG8_STAGE(PG8_SB(1, 0), b3, voffB); PG8_STAGE(PG8_SB(1, 1), b3 + hstep, voffB); PG8_STAGE(PG8_SA(1, 0), a3, voffA);
            PG8_WAIT_V(8); PG8_WAIT_L(0); PG8_BAR; PG8_MMA(1, 0, At, B0); PG8_MMA(1, 1, At, B1); PG8_BAR; PG8_SCHED;
            } else {
            PG8_LDB(B0, 0, 0); PG8_SCHED; PG8_LDA(At, 0, 0); PG8_STAGE(PG8_SA(1, 1), a1 + hstep, voffA);
            PG8_WAIT_L(8); PG8_BAR; PG8_WAIT_L(0); PG8_MMA(0, 0, At, B0); PG8_BAR; PG8_SCHED;
            PG8_LDB(B1, 0, 1); PG8_STAGE(PG8_SB(0, 0), b2, voffB);
            PG8_BAR; PG8_WAIT_L(0); PG8_MMA(0, 1, At, B1); PG8_BAR;
            PG8_LDA(At, 0, 1); PG8_STAGE(PG8_SA(0, 0), a2, voffA);
            PG8_BAR; PG8_WAIT_L(0); PG8_MMA(1, 0, At, B0); PG8_BAR; PG8_SCHED;
            PG8_STAGE(PG8_SB(0, 1), b2 + hstep, voffB);
            PG8_WAIT_V(6); PG8_BAR; PG8_MMA(1, 1, At, B1); PG8_BAR;
            PG8_LDB(B0, 1, 0); PG8_SCHED; PG8_LDA(At, 1, 0); PG8_STAGE(PG8_SA(0, 1), a2 + hstep, voffA);
            PG8_WAIT_L(8); PG8_BAR; PG8_WAIT_L(0); PG8_MMA(0, 0, At, B0); PG8_BAR; PG8_SCHED;
            PG8_LDB(B1, 1, 1); PG8_STAGE(PG8_SB(1, 0), b3, voffB);
            PG8_BAR; PG8_WAIT_L(0); PG8_MMA(0, 1, At, B1); PG8_BAR;
            PG8_LDA(At, 1, 1); PG8_STAGE(PG8_SA(1, 0), a3, voffA);
            PG8_BAR; PG8_WAIT_L(0); PG8_MMA(1, 0, At, B0); PG8_BAR; PG8_SCHED;
            PG8_STAGE(PG8_SB(1, 1), b3 + hstep, voffB);
            PG8_WAIT_V(6); PG8_BAR; PG8_MMA(1, 1, At, B1); PG8_BAR;
            }
        }
        if constexpr (ALIGN_EPI) { if (wr == 0) PG8_BAR; }
        if constexpr (!Epi::AFTER_DRAIN) { E(acc, cur, wr, wc, fr, fq); S.done(cur); }
        if (!has_next) break;
#pragma unroll
        for (int a = 0; a < 2; ++a)
#pragma unroll
            for (int b = 0; b < 2; ++b)
#pragma unroll
                for (int m = 0; m < 4; ++m)
#pragma unroll
                    for (int n = 0; n < 2; ++n) acc[a][b][m][n] = (f32x4){0.f, 0.f, 0.f, 0.f};
        cur = nxt; cA = nA; cB = nB; ++ui;
        if constexpr (ALIGN_EPI) { if (wr == 1) PG8_BAR; }
    }
    PG8_WAIT_V(0);
    if constexpr (!ALIGN_EPI) { if (wr == 0) PG8_BAR; }
    PG8_BAR;
    if constexpr (Epi::AFTER_DRAIN) { E.fused(acc, cur, wr, wc, fr, fq, lds, wid, lane); S.done(cur); }
#undef PG8_SA
#undef PG8_SB
#undef PG8_STAGE
#undef PG8_LDA
#undef PG8_LDB
#undef PG8_MMA
#undef PG8_WAIT_V
#undef PG8_WAIT_L
#undef PG8_BAR
#undef PG8_SCHED
}
}
#define GAS __attribute__((address_space(1)))
#define LAS __attribute__((address_space(3)))
typedef unsigned short bf16;
typedef unsigned v4u __attribute__((ext_vector_type(4)));
typedef float f32x4 __attribute__((ext_vector_type(4)));
typedef short bf16x8 __attribute__((ext_vector_type(8)));
typedef GAS unsigned gu32;
typedef GAS unsigned long long gu64;
#define RLX_AGENT __ATOMIC_RELAXED, __HIP_MEMORY_SCOPE_AGENT
#define LDS_WAIT() asm volatile("s_waitcnt lgkmcnt(0)" ::: "memory")
#define VM_WAIT() asm volatile("s_waitcnt vmcnt(0)" ::: "memory")
__device__ __forceinline__ unsigned long long rt() { return __builtin_amdgcn_s_memrealtime(); }
__device__ __forceinline__ unsigned f2bf(float f) { unsigned u = __builtin_bit_cast(unsigned, f); return (u + 0x7fffu + ((u >> 16) & 1u)) >> 16; }
__device__ __forceinline__ unsigned pk2(float lo, float hi) { return f2bf(lo) | (f2bf(hi) << 16); }

#define XB_TMO      128
#define XB_XCNT(j)  (256  + 64 * (j))
#define XB_XSUB(j)  (1280 + 64 * (j))
#define XB_XGEN(j)  (2304 + 64 * (j))
#define XB_TOP      3328
#define XB_TOPGEN   3392
#define XCD_BAR_WORDS 3456
#define XB_SPIN_CAP (1u << 18)

__device__ __forceinline__ unsigned xb_ld(unsigned* p)              { return __hip_atomic_load(p, __ATOMIC_RELAXED, __HIP_MEMORY_SCOPE_AGENT); }
__device__ __forceinline__ unsigned xb_add(unsigned* p, unsigned v) { return __hip_atomic_fetch_add(p, v, __ATOMIC_RELAXED, __HIP_MEMORY_SCOPE_AGENT); }
__device__ __forceinline__ unsigned xb_xcc_id() { return (unsigned)__builtin_amdgcn_s_getreg((3 << 11) | 20) & 0xFu; }
#define XB_SPIN(cond, bar) do { unsigned _sp = 0; while (cond) { __builtin_amdgcn_s_sleep(1); \
    if ((++_sp & 255u) == 0u) { if (xb_ld(&(bar)[XB_TMO])) break; if (_sp > XB_SPIN_CAP) { atomicAdd(&(bar)[XB_TMO], 1u); break; } } } } while (0)

struct XcdBarrier {
    unsigned* bar; unsigned x;
    volatile LAS unsigned* st;
};

__device__ __forceinline__ XcdBarrier xcd_barrier_post(unsigned* bar, volatile LAS unsigned* st) {
    XcdBarrier b; b.bar = bar; b.x = xb_xcc_id(); b.st = st;
    if (threadIdx.x == 0) (void)xb_add(&bar[XB_XCNT(b.x)], 1u);
    return b;
}
__device__ __forceinline__ void xcd_barrier_complete(unsigned* bar, unsigned x, unsigned& nloc, unsigned& nx) {
    const unsigned G = gridDim.x * gridDim.y * gridDim.z;
    unsigned sum, cnt, mine, sp = 0u;
    for (;;) {
        sum = 0u; cnt = 0u; mine = 0u;
#pragma unroll
        for (unsigned j = 0; j < 16; ++j) { const unsigned c = xb_ld(&bar[XB_XCNT(j)]); sum += c; cnt += (c > 0u) ? 1u : 0u; mine = (j == x) ? c : mine; }
        if (sum == G) break;
        __builtin_amdgcn_s_sleep(1);
        if ((++sp & 255u) == 0u) { if (xb_ld(&bar[XB_TMO])) break; if (sp > XB_SPIN_CAP) { atomicAdd(&bar[XB_TMO], 1u); break; } }
    }
    nloc = mine > 0u ? mine : 1u; nx = cnt > 0u ? cnt : 1u;
}

__device__ __forceinline__ void xcd_barrier(const XcdBarrier& b) {
    asm volatile("s_waitcnt vmcnt(0)" ::: "memory");
    __syncthreads();
    if (threadIdx.x == 0) {
        unsigned* bar = b.bar;
        __builtin_amdgcn_s_waitcnt(0);
        unsigned nloc = b.st[0], nx = b.st[1];
        if (nloc == 0u) { xcd_barrier_complete(bar, b.x, nloc, nx); b.st[0] = nloc; b.st[1] = nx; }
        const unsigned old = xb_add(&bar[XB_XSUB(b.x)], 1u);
        const unsigned gen = old / nloc;
        if (old + 1u == (gen + 1u) * nloc) {
            __builtin_amdgcn_fence(__ATOMIC_RELEASE, "agent");
            asm volatile("s_waitcnt vmcnt(0)" ::: "memory");
            const unsigned og = xb_add(&bar[XB_TOP], 1u);
            const unsigned tg = og / nx;
            if (og + 1u == (tg + 1u) * nx) xb_add(&bar[XB_TOPGEN], 1u);
            else XB_SPIN(xb_ld(&bar[XB_TOPGEN]) == tg, bar);
            __builtin_amdgcn_fence(__ATOMIC_ACQUIRE, "agent");
            xb_add(&bar[XB_XGEN(b.x)], 1u);
            asm volatile("s_waitcnt vmcnt(0)" ::: "memory");
        } else {
            XB_SPIN(xb_ld(&bar[XB_XGEN(b.x)]) == gen, bar);
            __builtin_amdgcn_fence(__ATOMIC_ACQUIRE, "agent");
            asm volatile("s_waitcnt vmcnt(0)" ::: "memory");
        }
    }
    __syncthreads();
}


constexpr int NWAVES = 8;
constexpr int BATCH = 4, T = 8192, D = 1024, FF = 4096, NPROJ = 2048, NMEM = 256;
constexpr int M = BATCH * T;
constexpr int MMEM = BATCH * NMEM;
constexpr float RMS_EPS = 1e-6f;
constexpr float C2 = 0.125f * 1.4426950408889634f;
constexpr float LOG2E = 1.4426950408889634f;
constexpr int COL_Q = 0, COL_K = 512, COL_V = 1024, COL_U = 1536, COL_QM = 1792;
constexpr int YC_ATTN = 0, YC_POOL = 512, YC_MEM = 768;

constexpr size_t MiB = 1u << 20;
constexpr size_t WS_CTL = 0, CTL_ZERO_BYTES = 1 * MiB;
constexpr size_t WS_KM = 1 * MiB, WS_VM = WS_KM + 512 * 1024;
constexpr size_t WS_SS = 2 * MiB;
constexpr size_t WS_WIN = 4 * MiB, WS_WO = 8 * MiB, WS_W1 = 10 * MiB, WS_W2 = 18 * MiB, WS_WMK = 26 * MiB, WS_WPT = 27 * MiB;
constexpr size_t WS_X = 28 * MiB;
constexpr size_t WS_MN = 29 * MiB;
constexpr size_t WS_XB = 32 * MiB;
constexpr size_t WS_H = 96 * MiB;
constexpr size_t WS_PROJ = 96 * MiB;
constexpr size_t WS_XN = 224 * MiB;
constexpr size_t WS_Y = 288 * MiB;
constexpr size_t WS_SS2 = 352 * MiB;
constexpr size_t WS_END = 354 * MiB;
static_assert(WS_H + (size_t)M * FF * 2 <= WS_SS2 && WS_Y + (size_t)M * D * 2 <= WS_SS2 && WS_XN + (size_t)M * D * 2 <= WS_Y && WS_PROJ + (size_t)M * NPROJ * 2 <= WS_XN && WS_XB + (size_t)M * D * 2 <= WS_H, "d_ws map");
constexpr int CW_TMO = 0, CW_CODE = 1;
constexpr int CW_BAR = 4096;
constexpr int CW_SEAM = 16384;
static_assert((CW_SEAM + 128 * 64) * 4 <= (int)CTL_ZERO_BYTES, "CTL words inside the memset region");

constexpr int RING_OFF = 0, RING_BYTES = 131072;
constexpr int AUX_OFF = RING_BYTES, AUX_BYTES = 8192;
constexpr int LDSCTL_OFF = AUX_OFF + AUX_BYTES, MISC_OFF = LDSCTL_OFF + 320;
constexpr int LDS_BYTES = 147456;
static_assert(MISC_OFF + 128 <= LDS_BYTES, "LDS map");

struct Frame {
    LAS unsigned char* lds;
    volatile LAS unsigned* MISC;
    gu32* ctl;
    int tid, lane, wave;
    int vcu, G;
    const float *x, *mem, *g_mix, *w_in, *g_mem, *w_mem_kv, *w_pool, *pool_scale, *w_out, *g_ffn, *w_ff1, *w_ff2, *g_final;
    float* out;
    bf16 *Win_t, *Wo_t, *W1_t, *W2_t, *Wmk_t, *WpT;
    bf16 *KM, *VM, *MN, *XB, *HB, *PROJ, *XN, *Y;
    float* SS; float* SS2;
};

__device__ __forceinline__ float wave_sum(float v) {
#pragma unroll
    for (int o = 1; o < 64; o <<= 1) v += __shfl_xor(v, o);
    return v;
}
__device__ __forceinline__ float wave_max(float v) {
#pragma unroll
    for (int o = 1; o < 64; o <<= 1) v = fmaxf(v, __shfl_xor(v, o));
    return v;
}
__device__ __forceinline__ float bf2f(bf16 b) { return __uint_as_float((unsigned)b << 16); }

__device__ __forceinline__ void p0_transpose_item(const float* W, int K, int N, bf16* WT, const float* kscale, LAS float* scr, int item, int lane) {
    const int nblk = N / 32, kb = item / nblk, nb = item % nblk, k0 = 64 * kb, n0 = 32 * nb;
#pragma unroll 8
    for (int i = 0; i < 32; ++i) { const int kk = 2 * i + (lane >> 5); float v = W[(size_t)(k0 + kk) * N + n0 + (lane & 31)]; if (kscale) v *= kscale[k0 + kk]; scr[kk * 33 + (lane & 31)] = v; }
    LDS_WAIT(); asm volatile("" ::: "memory");
    const int c = lane & 7;
#pragma unroll
    for (int j = 0; j < 4; ++j) { const int n = (lane >> 3) + 8 * j; const LAS float* s = scr + (8 * c) * 33 + n;
        v4u o; o.x = pk2(s[0 * 33], s[1 * 33]); o.y = pk2(s[2 * 33], s[3 * 33]); o.z = pk2(s[4 * 33], s[5 * 33]); o.w = pk2(s[6 * 33], s[7 * 33]);
        *(GAS v4u*)(WT + (size_t)(n0 + n) * K + k0 + 8 * c) = o; }
    LDS_WAIT(); asm volatile("" ::: "memory");
}
__device__ __forceinline__ void rms_row_to_bf16(int lane, const float* xrow, const float* g, bf16* orow) {
    const GAS f32x4* xr = (const GAS f32x4*)xrow + lane; const GAS f32x4* gr = (const GAS f32x4*)g + lane;
    f32x4 v[4]; float s = 0.f;
#pragma unroll
    for (int j = 0; j < 4; ++j) { v[j] = xr[64 * j]; s += (v[j].x * v[j].x + v[j].y * v[j].y) + (v[j].z * v[j].z + v[j].w * v[j].w); }
    const float rinv = 1.f / sqrtf(wave_sum(s) * (1.f / D) + RMS_EPS);
    GAS unsigned long long* o8 = (GAS unsigned long long*)orow + lane;
#pragma unroll
    for (int j = 0; j < 4; ++j) { const f32x4 gg = gr[64 * j];
        o8[64 * j] = (unsigned long long)pk2(v[j].x * rinv * gg.x, v[j].y * rinv * gg.y) | ((unsigned long long)pk2(v[j].z * rinv * gg.z, v[j].w * rinv * gg.w) << 32); }
}
__device__ __forceinline__ void rms_row2_to_bf16(int lane, const float* xa, const float* ga, bf16* oa, const float* xb_, const float* gb, bf16* ob) {
    const GAS f32x4* xr = (const GAS f32x4*)xa + lane; const GAS f32x4* yr = (const GAS f32x4*)xb_ + lane;
    f32x4 v[4], w[4]; float s = 0.f, t = 0.f;
#pragma unroll
    for (int j = 0; j < 4; ++j) { v[j] = xr[64 * j]; w[j] = yr[64 * j]; }
#pragma unroll
    for (int j = 0; j < 4; ++j) { s += (v[j].x * v[j].x + v[j].y * v[j].y) + (v[j].z * v[j].z + v[j].w * v[j].w); t += (w[j].x * w[j].x + w[j].y * w[j].y) + (w[j].z * w[j].z + w[j].w * w[j].w); }
    const float ra = 1.f / sqrtf(wave_sum(s) * (1.f / D) + RMS_EPS), rb = 1.f / sqrtf(wave_sum(t) * (1.f / D) + RMS_EPS);
    const GAS f32x4* gr = (const GAS f32x4*)ga + lane; const GAS f32x4* hr = (const GAS f32x4*)gb + lane;
    GAS unsigned long long* o8 = (GAS unsigned long long*)oa + lane; GAS unsigned long long* p8 = (GAS unsigned long long*)ob + lane;
#pragma unroll
    for (int j = 0; j < 4; ++j) { const f32x4 gg = gr[64 * j], hh = hr[64 * j];
        o8[64 * j] = (unsigned long long)pk2(v[j].x * ra * gg.x, v[j].y * ra * gg.y) | ((unsigned long long)pk2(v[j].z * ra * gg.z, v[j].w * ra * gg.w) << 32);
        p8[64 * j] = (unsigned long long)pk2(w[j].x * rb * hh.x, w[j].y * rb * hh.y) | ((unsigned long long)pk2(w[j].z * rb * hh.z, w[j].w * rb * hh.w) << 32); }
}
__device__ __forceinline__ void p0_prologue(Frame& F) {
    LAS float* scr = (LAS float*)(F.lds + RING_OFF + F.wave * 16384);
    const int gw = F.vcu * NWAVES + F.wave, NGW = F.G * NWAVES;
    constexpr int I_IN = (D / 64) * (NPROJ / 32), I_O = (D / 64) * (D / 32), I_1 = (D / 64) * (FF / 32), I_2 = (FF / 64) * (D / 32), I_MK = (D / 64) * (512 / 32), I_P = 4 * 2;
    constexpr int NITEMS = I_IN + I_O + I_1 + I_2 + I_MK + I_P;
    for (int it = gw; it < NITEMS; it += NGW) {
        int r = it;
        if (r < I_IN) { p0_transpose_item(F.w_in, D, NPROJ, F.Win_t, nullptr, scr, r, F.lane); continue; } r -= I_IN;
        if (r < I_O) { p0_transpose_item(F.w_out, D, D, F.Wo_t, nullptr, scr, r, F.lane); continue; } r -= I_O;
        if (r < I_1) { p0_transpose_item(F.w_ff1, D, FF, F.W1_t, F.g_ffn, scr, r, F.lane); continue; } r -= I_1;
        if (r < I_2) { p0_transpose_item(F.w_ff2, FF, D, F.W2_t, nullptr, scr, r, F.lane); continue; } r -= I_2;
        if (r < I_MK) { p0_transpose_item(F.w_mem_kv, D, 512, F.Wmk_t, nullptr, scr, r, F.lane); continue; } r -= I_MK;
        { const int g = r >> 1; p0_transpose_item(F.w_pool + g * 4096, 64, 64, F.WpT + g * 4096, nullptr, scr, r & 1, F.lane); }
    }
    for (int m = gw; m < M + MMEM; m += 2 * NGW) {
        const int m2 = m + NGW;
        const float* r0 = (m < M) ? F.x + (size_t)m * D : F.mem + (size_t)(m - M) * D; const float* g0 = (m < M) ? F.g_mix : F.g_mem; bf16* o0 = (m < M) ? F.XN + (size_t)m * D : F.MN + (size_t)(m - M) * D;
        if (m2 < M + MMEM) {
            const float* r1 = (m2 < M) ? F.x + (size_t)m2 * D : F.mem + (size_t)(m2 - M) * D; const float* g1 = (m2 < M) ? F.g_mix : F.g_mem; bf16* o1 = (m2 < M) ? F.XN + (size_t)m2 * D : F.MN + (size_t)(m2 - M) * D;
            rms_row2_to_bf16(F.lane, r0, g0, o0, r1, g1, o1);
        } else rms_row_to_bf16(F.lane, r0, g0, o0);
    }
}

typedef float f32x16 __attribute__((ext_vector_type(16)));
__device__ __forceinline__ int crow(int r, int hi) { return (r & 3) + 8 * (r >> 2) + 4 * hi; }
__device__ __forceinline__ void p1_memkv(Frame& F) {
    LAS float* red = (LAS float*)(F.lds + RING_OFF);
    const int r32 = F.lane & 31, hi = F.lane >> 5;
    for (int tile = F.vcu; tile < (MMEM / 64) * (512 / 32); tile += F.G) {
        const int tm = tile >> 4, tn = tile & 15, k0 = F.wave * 128;
        const bf16* a0 = F.MN + (size_t)(tm * 64 + r32) * D + k0 + hi * 8;
        const bf16* b0 = F.Wmk_t + (size_t)(tn * 32 + r32) * D + k0 + hi * 8;
        f32x16 acc0 = {}, acc1 = {};
#pragma unroll
        for (int ks = 0; ks < 8; ++ks) {
            const bf16x8 av0 = *(const bf16x8*)(a0 + ks * 16), av1 = *(const bf16x8*)(a0 + (size_t)32 * D + ks * 16), bv = *(const bf16x8*)(b0 + ks * 16);
            acc0 = __builtin_amdgcn_mfma_f32_32x32x16_bf16(av0, bv, acc0, 0, 0, 0);
            acc1 = __builtin_amdgcn_mfma_f32_32x32x16_bf16(av1, bv, acc1, 0, 0, 0);
        }
#pragma unroll
        for (int r = 0; r < 16; ++r) { red[((F.wave * 2 + 0) * 16 + r) * 64 + F.lane] = acc0[r]; red[((F.wave * 2 + 1) * 16 + r) * 64 + F.lane] = acc1[r]; }
        __syncthreads();
#pragma unroll
        for (int q = 0; q < 4; ++q) { const int e = F.tid + 512 * q, l = e & 63, r = (e >> 6) & 15, rb = e >> 10; float s = 0.f;
#pragma unroll
            for (int w = 0; w < 8; ++w) s += red[((w * 2 + rb) * 16 + r) * 64 + l];
            const int row = tm * 64 + rb * 32 + crow(r, l >> 5), col = tn * 32 + (l & 31);
            bf16* dst = (col < 256) ? F.KM + (size_t)row * 256 + col : F.VM + (size_t)row * 256 + (col - 256);
            *dst = (bf16)f2bf(s); }
        __syncthreads();
    }
}


typedef unsigned u32x4 __attribute__((ext_vector_type(4)));
namespace mix {
typedef short s16x4 __attribute__((ext_vector_type(4)));
typedef short v4i16_t __attribute__((ext_vector_type(4)));
typedef __attribute__((address_space(3))) const char* lds_cptr;
__device__ __forceinline__ void glds16(const void* gsrc, unsigned lds_dst) { unsigned keep;
    asm volatile("s_mov_b32 %0, m0\n\ts_mov_b32 m0, %2\n\ts_nop 0\n\tglobal_load_lds_dwordx4 %1, off\n\ts_mov_b32 m0, %0" : "=&s"(keep) : "v"(gsrc), "s"(lds_dst) : "memory"); }
__device__ __forceinline__ s16x4 vtr(lds_cptr p) { return __builtin_bit_cast(s16x4, __builtin_amdgcn_ds_read_tr16_b64_v4i16((__attribute__((address_space(3))) v4i16_t*)p)); }
__device__ __forceinline__ unsigned cvtpk(float lo, float hi) { typedef float f2 __attribute__((ext_vector_type(2))); typedef __bf16 b2 __attribute__((ext_vector_type(2))); f2 v = {lo, hi}; b2 b = __builtin_convertvector(v, b2); return __builtin_bit_cast(unsigned, b); }
#define MIX_VMWAIT(N) asm volatile("s_waitcnt vmcnt(" #N ")" ::: "memory")

constexpr int RING_SLOTS = 4, SLOT_BYTES = 4096, WAVE_RING = RING_SLOTS * SLOT_BYTES;

struct JobOut {
    bf16* y0; size_t ystride;
    LAS float* lse0; int lstride;
};

template <int MODE>
__device__ __forceinline__ void job_store(f32x16 (&o)[2], float rowf, float wold, const JobOut& J, LAS unsigned char* ring, LAS float* wsf, int lane) {
    asm volatile("" : "+v"(lane));
    const int r32 = lane & 31, hi = lane >> 5;
    if (hi == 0) { wsf[r32] = rowf; if (MODE == 2) wsf[32 + r32] = wold; }
    u32x4 oldv[4];
    if (MODE == 2) {
#pragma unroll
        for (int i = 0; i < 4; ++i) { const int row = i * 8 + (lane >> 3), ch = lane & 7; oldv[i] = *(const u32x4*)(J.y0 + (size_t)row * J.ystride + ch * 8); }
    }
    asm volatile("s_waitcnt lgkmcnt(0)" ::: "memory");
    LAS bf16* stg = (LAS bf16*)(ring);
    f32x4 fr[4];
#pragma unroll
    for (int g = 0; g < 4; ++g) fr[g] = *(const LAS f32x4*)(wsf + 8 * g + 4 * hi);
#pragma unroll
    for (int r = 0; r < 16; ++r) { const int orow = crow(r, hi); const float f = fr[r >> 2][r & 3];
#pragma unroll
        for (int d0 = 0; d0 < 2; ++d0) stg[orow * 64 + d0 * 32 + r32] = (bf16)f2bf(o[d0][r] * f); }
    asm volatile("s_waitcnt lgkmcnt(0)" ::: "memory");
#pragma unroll
    for (int i = 0; i < 4; ++i) { const int row = i * 8 + (lane >> 3), ch = lane & 7; u32x4 v = *(const LAS u32x4*)(stg + row * 64 + ch * 8);
        if (MODE == 2) { const float w = wsf[32 + row];
#pragma unroll
            for (int e = 0; e < 4; ++e) { const unsigned a = oldv[i][e], b = v[e];
                const float lo = __uint_as_float(a << 16) * w + __uint_as_float(b << 16), hv = __uint_as_float(a & 0xffff0000u) * w + __uint_as_float(b & 0xffff0000u);
                v[e] = cvtpk(lo, hv); } }
        *(u32x4*)(J.y0 + (size_t)row * J.ystride + ch * 8) = v; }
    asm volatile("s_waitcnt lgkmcnt(0)" ::: "memory");
}

template <int NT, bool BAND, int MODE>
__device__ __forceinline__ void attn_job(const bf16* q0, size_t qstride, const bf16* kb, const bf16* vb, size_t kvstride, int krow0, int krstep, float sl, int jstart,
                                         const JobOut& J, LAS unsigned char* ring, LAS float* wsf, int lane) {
    asm volatile("" : "+v"(lane));
    const int r32 = lane & 31, hi = lane >> 5;
    const unsigned ring_lds = (unsigned)(uintptr_t)ring;
    asm volatile("s_waitcnt lgkmcnt(0)" ::: "memory");
    const int vrow_l = lane >> 3, vch = lane & 7;
#define MIX_VROW(j) ((BAND) ? max(krow0 + krstep * (j), 0) : (krow0 + krstep * (j)))
#define MIX_DMA_V(kt) do { _Pragma("unroll") for (int i_ = 0; i_ < 4; ++i_) { const int j_ = 32 * (kt) + 8 * i_ + vrow_l; \
        glds16(vb + (size_t)MIX_VROW(j_) * kvstride + vch * 8, (unsigned)__builtin_amdgcn_readfirstlane(ring_lds + ((kt) % RING_SLOTS) * SLOT_BYTES + i_ * 1024)); } } while (0)
#pragma unroll
    for (int kt = 0; kt < (NT < RING_SLOTS ? NT : RING_SLOTS); ++kt) MIX_DMA_V(kt);
    bf16x8 qr[4];
#pragma unroll
    for (int ks = 0; ks < 4; ++ks) qr[ks] = *(const bf16x8*)(q0 + (size_t)r32 * qstride + ks * 16 + hi * 8);
    bf16x8 kf[NT][4];
#pragma unroll
    for (int kt = 0; kt < NT; ++kt) { const bf16* kr = kb + (size_t)MIX_VROW(32 * kt + r32) * kvstride + hi * 8;
#pragma unroll
        for (int ks = 0; ks < 4; ++ks) kf[kt][ks] = *(const bf16x8*)(kr + ks * 16); }
    __builtin_amdgcn_sched_barrier(0);
    f32x16 p[NT];
#pragma unroll
    for (int kt = 0; kt < NT; ++kt) { f32x16 acc = {};
#pragma unroll
        for (int ks = 0; ks < 4; ++ks) acc = __builtin_amdgcn_mfma_f32_32x32x16_bf16(kf[kt][ks], qr[ks], acc, 0, 0, 0);
        p[kt] = acc; }
    __builtin_amdgcn_sched_barrier(0);
    float mx = -INFINITY;
    if (BAND) {
        const float NEG = -INFINITY; const int lob = max(r32, jstart);
#pragma unroll
        for (int kt = 0; kt < NT; ++kt) {
#pragma unroll
            for (int r = 0; r < 16; ++r) { const int j = 32 * kt + crow(r, hi); float s = p[kt][r] + sl * (float)(128 + r32 - j);
                if (kt == 0) s = (j >= lob) ? s : NEG;
                if (kt == NT - 1) s = (j <= r32 + 128) ? s : NEG;
                p[kt][r] = s; }
            if (kt > 0 && kt < NT - 1 && jstart > 32 * kt) {
#pragma unroll
                for (int r = 0; r < 16; ++r) { const int j = 32 * kt + crow(r, hi); p[kt][r] = (j >= jstart) ? p[kt][r] : NEG; } }
#pragma unroll
            for (int r = 0; r < 16; ++r) mx = fmaxf(mx, p[kt][r]);
        }
    } else {
#pragma unroll
        for (int kt = 0; kt < NT; ++kt)
#pragma unroll
            for (int r = 0; r < 16; ++r) mx = fmaxf(mx, p[kt][r]);
    }
    mx = fmaxf(mx, __shfl_xor(mx, 32));
    float l = 0.f;
#pragma unroll
    for (int kt = 0; kt < NT; ++kt)
#pragma unroll
        for (int r = 0; r < 16; ++r) { const float e = __builtin_amdgcn_exp2f(p[kt][r] - mx); p[kt][r] = e; l += e; }
    l += __shfl_xor(l, 32);
    u32x4 pw[NT][2];
#pragma unroll
    for (int kt = 0; kt < NT; ++kt)
#pragma unroll
        for (int s = 0; s < 2; ++s) { pw[kt][s].x = cvtpk(p[kt][8 * s + 0], p[kt][8 * s + 1]); pw[kt][s].y = cvtpk(p[kt][8 * s + 2], p[kt][8 * s + 3]);
                                      pw[kt][s].z = cvtpk(p[kt][8 * s + 4], p[kt][8 * s + 5]); pw[kt][s].w = cvtpk(p[kt][8 * s + 6], p[kt][8 * s + 7]); }
    float rowf = 1.0f / l, wold = 0.f;
    if (MODE >= 1) {
        const float lse = mx + __log2f(l);
        if (MODE == 1) { if (hi == 0) J.lse0[r32 * J.lstride] = lse; }
        else { const float old = J.lse0[r32 * J.lstride]; const float mm = fmaxf(old, lse); const float eo = __builtin_amdgcn_exp2f(old - mm), ej = __builtin_amdgcn_exp2f(lse - mm), tot = eo + ej;
               const float it = 1.0f / tot; wold = eo * it; rowf = ej * it * rowf; if (hi == 0) J.lse0[r32 * J.lstride] = mm + __log2f(tot); }
    }
    f32x16 o[2]; o[0] = f32x16{}; o[1] = f32x16{};
    const lds_cptr vp0 = (lds_cptr)ring + ((4 * hi + ((lane & 15) >> 2)) * 128 + ((lane >> 4) & 1) * 32 + (lane & 3) * 8);
    MIX_VMWAIT(0);
#pragma unroll
    for (int kt = 0; kt < NT; ++kt) {
        if (kt >= RING_SLOTS) {
            constexpr int dummy = 0; (void)dummy;
            const int newer = ((NT - 1 < kt + 3) ? (NT - 1) : (kt + 3)) - kt;
            if (newer == 0) MIX_VMWAIT(0); else if (newer == 1) MIX_VMWAIT(4); else if (newer == 2) MIX_VMWAIT(8); else MIX_VMWAIT(12);
        }
        const lds_cptr vp = vp0 + (kt % RING_SLOTS) * SLOT_BYTES;
#pragma unroll
        for (int d0 = 0; d0 < 2; ++d0)
#pragma unroll
            for (int s = 0; s < 2; ++s) { const s16x4 lo = vtr(vp + s * 2048 + d0 * 64), hv = vtr(vp + s * 2048 + 1024 + d0 * 64);
                const bf16x8 vf = (bf16x8){lo[0], lo[1], lo[2], lo[3], hv[0], hv[1], hv[2], hv[3]};
                o[d0] = __builtin_amdgcn_mfma_f32_32x32x16_bf16(__builtin_bit_cast(bf16x8, pw[kt][s]), vf, o[d0], 0, 0, 0); }
        if (kt + RING_SLOTS < NT) { asm volatile("s_waitcnt lgkmcnt(0)" ::: "memory"); MIX_DMA_V(kt + RING_SLOTS); }
    }
    asm volatile("s_waitcnt lgkmcnt(0)" ::: "memory");
    job_store<MODE>(o, rowf, wold, J, ring, wsf, lane);
#undef MIX_VROW
#undef MIX_DMA_V
}

__device__ __forceinline__ void pool_job(const bf16* u0  , int t0  , int g, const bf16* WpTg, const float* pscale_g,
                                         const JobOut& J, LAS unsigned char* ring, LAS float* wsf, int lane) {
    asm volatile("" : "+v"(lane));
    const int r32 = lane & 31, hi = lane >> 5, w = 2 << g, t = t0 + r32, cnt = min(w, t + 1);
    float acc[32];
#pragma unroll
    for (int i = 0; i < 32; ++i) acc[i] = 0.f;
    u32x4 self[4];
    const bf16* up = u0 + (size_t)r32 * NPROJ + hi * 8;
    for (int i = 0; i < cnt; ++i) {
#pragma unroll
        for (int ks = 0; ks < 4; ++ks) { const u32x4 v = *(const u32x4*)(up - (ptrdiff_t)i * NPROJ + ks * 16); if (i == 0) self[ks] = v;
#pragma unroll
            for (int e = 0; e < 4; ++e) { acc[ks * 8 + 2 * e] += __uint_as_float(v[e] << 16); acc[ks * 8 + 2 * e + 1] += __uint_as_float(v[e] & 0xffff0000u); } }
    }
    const float ic = 1.0f / (float)cnt;
    bf16x8 af[4];
#pragma unroll
    for (int ks = 0; ks < 4; ++ks) { u32x4 a;
#pragma unroll
        for (int e = 0; e < 4; ++e) a[e] = cvtpk(acc[ks * 8 + 2 * e] * ic - __uint_as_float(self[ks][e] << 16), acc[ks * 8 + 2 * e + 1] * ic - __uint_as_float(self[ks][e] & 0xffff0000u));
        af[ks] = __builtin_bit_cast(bf16x8, a); }
    f32x16 o[2]; o[0] = f32x16{}; o[1] = f32x16{};
#pragma unroll
    for (int eh = 0; eh < 2; ++eh) { const bf16* bp = WpTg + (size_t)(eh * 32 + r32) * 64 + hi * 8; const float ps = pscale_g[eh * 32 + r32];
#pragma unroll
        for (int ks = 0; ks < 4; ++ks) o[eh] = __builtin_amdgcn_mfma_f32_32x32x16_bf16(af[ks], *(const bf16x8*)(bp + ks * 16), o[eh], 0, 0, 0);
#pragma unroll
        for (int r = 0; r < 16; ++r) o[eh][r] *= ps; }
    job_store<0>(o, 1.0f, 0.f, J, ring, wsf, lane);
}
}

__device__ __forceinline__ void p2_mixer(Frame& F) {
    LAS unsigned char* ring = F.lds + RING_OFF + F.wave * mix::WAVE_RING;
    LAS float* lse_tab = (LAS float*)(F.lds + AUX_OFF);
    LAS float* wsf = (LAS float*)(F.lds + AUX_OFF + 2048) + F.wave * 64;
    const int lane = F.lane, wv = F.wave;
    constexpr int NBLK = T / 512;
    for (int un = F.vcu; un < BATCH * 8 * NBLK; un += F.G) {
        const int blk = un % NBLK, h = (un / NBLK) % 8, b = un / (NBLK * 8), t0 = blk * 512;
        const bf16* pb = F.PROJ + (size_t)b * T * NPROJ;
        const bf16* kb = pb + COL_K + h * 64; const bf16* vb = pb + COL_V + h * 64; const bf16* qb = pb + COL_Q + h * 64;
        bf16* yb = F.Y + (size_t)b * T * D + YC_ATTN + h * 64;
        const float slope = -exp2f(-(float)(h + 1)) * LOG2E;
#pragma unroll 1
        for (int jq = wv; jq < 16; jq += NWAVES) { const int tq0 = t0 + 32 * jq;
            mix::JobOut J{yb + (size_t)tq0 * D, (size_t)D, lse_tab + 32 * jq, 1};
            mix::attn_job<5, true, 1>(qb + (size_t)tq0 * NPROJ, (size_t)NPROJ, kb, vb, (size_t)NPROJ, tq0 - 128, 1, slope, 128 - tq0, J, ring, wsf, lane); }
        VM_WAIT(); __syncthreads();
#pragma unroll 1
        for (int id = wv; id < 16; id += NWAVES) { const int r = id >> 2, jq = id & 3, tq0 = t0 + r + 4 * 32 * jq, iq0 = (t0 >> 2) + 32 * jq;
            mix::JobOut J{yb + (size_t)tq0 * D, (size_t)4 * D, lse_tab + (tq0 - t0), 4};
            mix::attn_job<5, true, 2>(qb + (size_t)tq0 * NPROJ, (size_t)4 * NPROJ, kb, vb, (size_t)NPROJ, tq0 - 128 * 4, 4, slope * 4.f, 128 - iq0, J, ring, wsf, lane); }
        VM_WAIT(); __syncthreads();
#pragma unroll 1
        for (int r = wv; r < 16; r += NWAVES) { const int tq0 = t0 + r, iq0 = t0 >> 4;
            mix::JobOut J{yb + (size_t)tq0 * D, (size_t)16 * D, lse_tab + r, 16};
            mix::attn_job<5, true, 2>(qb + (size_t)tq0 * NPROJ, (size_t)16 * NPROJ, kb, vb, (size_t)NPROJ, tq0 - 128 * 16, 16, slope * 16.f, 128 - iq0, J, ring, wsf, lane); }
        VM_WAIT(); __syncthreads();
    }
    for (int un = F.vcu; un < BATCH * 4 * NBLK; un += F.G) {
        const int blk = un % NBLK, h = (un / NBLK) % 4, b = un / (NBLK * 4), t0 = blk * 512;
        const bf16* qb = F.PROJ + (size_t)b * T * NPROJ + COL_QM + h * 64;
        const bf16* kb = F.KM + (size_t)b * NMEM * 256 + h * 64; const bf16* vb = F.VM + (size_t)b * NMEM * 256 + h * 64;
        bf16* yb = F.Y + (size_t)b * T * D + YC_MEM + h * 64;
#pragma unroll 1
        for (int jq = wv; jq < 16; jq += NWAVES) { const int tq0 = t0 + 32 * jq;
            mix::JobOut J{yb + (size_t)tq0 * D, (size_t)D, lse_tab + 32 * jq, 1};
            mix::attn_job<4, false, 1>(qb + (size_t)tq0 * NPROJ, (size_t)NPROJ, kb, vb, (size_t)256, 0, 1, 0.f, 0, J, ring, wsf, lane);
            VM_WAIT();
            mix::attn_job<4, false, 2>(qb + (size_t)tq0 * NPROJ, (size_t)NPROJ, kb, vb, (size_t)256, 128, 1, 0.f, 0, J, ring, wsf, lane); }
    }
    for (int un = F.vcu; un < BATCH * 4 * NBLK; un += F.G) {
        const int blk = un % NBLK, g = (un / NBLK) % 4, b = un / (NBLK * 4), t0 = blk * 512;
        const bf16* ub = F.PROJ + (size_t)b * T * NPROJ + COL_U + g * 64;
        bf16* yb = F.Y + (size_t)b * T * D + YC_POOL + g * 64;
#pragma unroll 1
        for (int jq = wv; jq < 16; jq += NWAVES) { const int tq0 = t0 + 32 * jq;
            mix::JobOut J{yb + (size_t)tq0 * D, (size_t)D, lse_tab, 0};
            mix::pool_job(ub + (size_t)tq0 * NPROJ, tq0, g, F.WpT + g * 4096, F.pool_scale + g * 64, J, ring, wsf, lane); }
    }
    VM_WAIT(); __syncthreads();
}
__device__ __forceinline__ void p2_naive(Frame& F) {
    LAS float* pbuf = (LAS float*)(F.lds + RING_OFF) + F.wave * 1024;
    const int gw = F.vcu * NWAVES + F.wave, NGW = F.G * NWAVES, lane = F.lane;
    for (int it = gw; it < M * 8; it += NGW) {
        const int m = it >> 3, h = it & 7, t = m & (T - 1);
        const bf16* qrow = F.PROJ + (size_t)m * NPROJ + COL_Q + h * 64;
        float q[64];
#pragma unroll
        for (int c = 0; c < 8; ++c) { const v4u w = *(const v4u*)(qrow + c * 8);
            q[c * 8 + 0] = __uint_as_float(w.x << 16); q[c * 8 + 1] = __uint_as_float(w.x & 0xffff0000u); q[c * 8 + 2] = __uint_as_float(w.y << 16); q[c * 8 + 3] = __uint_as_float(w.y & 0xffff0000u);
            q[c * 8 + 4] = __uint_as_float(w.z << 16); q[c * 8 + 5] = __uint_as_float(w.z & 0xffff0000u); q[c * 8 + 6] = __uint_as_float(w.w << 16); q[c * 8 + 7] = __uint_as_float(w.w & 0xffff0000u); }
        const float slope = exp2f(-(float)(h + 1)) * LOG2E;
        float s[9]; float mx = -INFINITY;
#pragma unroll
        for (int br = 0; br < 3; ++br) { const int dd = br == 0 ? 1 : (br == 1 ? 4 : 16);
#pragma unroll
            for (int ch = 0; ch < 3; ++ch) { const int j = ch * 64 + lane; const int tk = t - dd * j; float sv = -INFINITY;
                if (j <= 128 && tk >= 0) { const bf16* krow = F.PROJ + (size_t)(m - dd * j) * NPROJ + COL_K + h * 64; float a = 0.f;
#pragma unroll
                    for (int c = 0; c < 8; ++c) { const v4u w = *(const v4u*)(krow + c * 8);
                        a += q[c * 8 + 0] * __uint_as_float(w.x << 16) + q[c * 8 + 1] * __uint_as_float(w.x & 0xffff0000u) + q[c * 8 + 2] * __uint_as_float(w.y << 16) + q[c * 8 + 3] * __uint_as_float(w.y & 0xffff0000u)
                           + q[c * 8 + 4] * __uint_as_float(w.z << 16) + q[c * 8 + 5] * __uint_as_float(w.z & 0xffff0000u) + q[c * 8 + 6] * __uint_as_float(w.w << 16) + q[c * 8 + 7] * __uint_as_float(w.w & 0xffff0000u); }
                    sv = a - slope * (float)(dd * j); }
                s[br * 3 + ch] = sv; mx = fmaxf(mx, sv); } }
        mx = wave_max(mx); float l = 0.f;
#pragma unroll
        for (int i = 0; i < 9; ++i) { const float p = exp2f(s[i] - mx); l += p; pbuf[i * 64 + lane] = p; }
        l = wave_sum(l);
        LDS_WAIT(); asm volatile("" ::: "memory");
        float o = 0.f;
#pragma unroll
        for (int br = 0; br < 3; ++br) { const int dd = br == 0 ? 1 : (br == 1 ? 4 : 16);
            const int jmax = min(128, t / dd);
            const bf16* vcol = F.PROJ + (size_t)m * NPROJ + COL_V + h * 64 + lane;
            for (int j = 0; j <= jmax; ++j) o += pbuf[(br * 3 + (j >> 6)) * 64 + (j & 63)] * bf2f(vcol[-(ptrdiff_t)dd * j * NPROJ]); }
        F.Y[(size_t)m * D + YC_ATTN + h * 64 + lane] = (bf16)f2bf(o / l);
        LDS_WAIT(); asm volatile("" ::: "memory");
    }
    for (int it = gw; it < M * 4; it += NGW) {
        const int m = it >> 2, h = it & 3, b = m / T;
        const bf16* qrow = F.PROJ + (size_t)m * NPROJ + COL_QM + h * 64;
        float q[64];
#pragma unroll
        for (int c = 0; c < 8; ++c) { const v4u w = *(const v4u*)(qrow + c * 8);
            q[c * 8 + 0] = __uint_as_float(w.x << 16); q[c * 8 + 1] = __uint_as_float(w.x & 0xffff0000u); q[c * 8 + 2] = __uint_as_float(w.y << 16); q[c * 8 + 3] = __uint_as_float(w.y & 0xffff0000u);
            q[c * 8 + 4] = __uint_as_float(w.z << 16); q[c * 8 + 5] = __uint_as_float(w.z & 0xffff0000u); q[c * 8 + 6] = __uint_as_float(w.w << 16); q[c * 8 + 7] = __uint_as_float(w.w & 0xffff0000u); }
        float s[4]; float mx = -INFINITY;
#pragma unroll
        for (int ch = 0; ch < 4; ++ch) { const bf16* krow = F.KM + (size_t)(b * NMEM + ch * 64 + lane) * 256 + h * 64; float a = 0.f;
#pragma unroll
            for (int c = 0; c < 8; ++c) { const v4u w = *(const v4u*)(krow + c * 8);
                a += q[c * 8 + 0] * __uint_as_float(w.x << 16) + q[c * 8 + 1] * __uint_as_float(w.x & 0xffff0000u) + q[c * 8 + 2] * __uint_as_float(w.y << 16) + q[c * 8 + 3] * __uint_as_float(w.y & 0xffff0000u)
                   + q[c * 8 + 4] * __uint_as_float(w.z << 16) + q[c * 8 + 5] * __uint_as_float(w.z & 0xffff0000u) + q[c * 8 + 6] * __uint_as_float(w.w << 16) + q[c * 8 + 7] * __uint_as_float(w.w & 0xffff0000u); }
            s[ch] = a; mx = fmaxf(mx, a); }
        mx = wave_max(mx); float l = 0.f;
#pragma unroll
        for (int i = 0; i < 4; ++i) { const float p = exp2f(s[i] - mx); l += p; pbuf[i * 64 + lane] = p; }
        l = wave_sum(l);
        LDS_WAIT(); asm volatile("" ::: "memory");
        float o = 0.f;
        const bf16* vcol = F.VM + (size_t)(b * NMEM) * 256 + h * 64 + lane;
        for (int j = 0; j < NMEM; ++j) o += pbuf[j] * bf2f(vcol[(size_t)j * 256]);
        F.Y[(size_t)m * D + YC_MEM + h * 64 + lane] = (bf16)f2bf(o / l);
        LDS_WAIT(); asm volatile("" ::: "memory");
    }
    for (int it = gw; it < M * 4; it += NGW) {
        const int m = it >> 2, g = it & 3, t = m & (T - 1), w = 2 << g, cnt = min(w, t + 1);
        const bf16* ucol = F.PROJ + (size_t)m * NPROJ + COL_U + g * 64 + lane;
        float sum = 0.f;
        for (int i = 0; i < cnt; ++i) sum += bf2f(ucol[-(ptrdiff_t)i * NPROJ]);
        const float d = sum / (float)cnt - bf2f(ucol[0]);
        pbuf[lane] = d;
        LDS_WAIT(); asm volatile("" ::: "memory");
        float o = 0.f;
        const float* wp = F.w_pool + g * 4096 + lane;
#pragma unroll 8
        for (int c = 0; c < 64; ++c) o += pbuf[c] * wp[c * 64];
        F.Y[(size_t)m * D + YC_POOL + g * 64 + lane] = (bf16)f2bf(o * F.pool_scale[g * 64 + lane]);
        LDS_WAIT(); asm volatile("" ::: "memory");
    }
}

struct RoundOrder {
    pg8::StaticOrder base; int round;
    __device__ __forceinline__ bool next(int i, pg8::Unit& u) const { if (i != 0) return false; return base.next(round, u); }
    __device__ __forceinline__ void a_ready(const pg8::Unit&) const {}
    __device__ __forceinline__ void done(const pg8::Unit&) const {}
};

struct DoubleOrder {
    pg8::StaticOrder base; int n;
    __device__ __forceinline__ bool next(int i, pg8::Unit& u) const { if (i >= 2 * n) return false; return base.next(i >= n ? i - n : i, u); }
    __device__ __forceinline__ void a_ready(const pg8::Unit&) const {}
    __device__ __forceinline__ void done(const pg8::Unit&) const {}
};
struct Args { const float* in[13]; float* out; unsigned char* ws; int ph_lo, ph_hi; };
#ifndef MK_P2_NAIVE
#define MK_P2_NAIVE 0
#endif
__global__ void __launch_bounds__(NWAVES * 64, 2) hymba_fwd(Args args) {
    extern __shared__ __attribute__((aligned(16))) unsigned char lds[];
    Frame F;
    F.lds = (LAS unsigned char*)lds;
    F.MISC = (volatile LAS unsigned*)(F.lds + MISC_OFF);
    F.tid = threadIdx.x; F.lane = F.tid & 63; F.wave = __builtin_amdgcn_readfirstlane(F.tid >> 6);
    F.G = gridDim.x; { const int bx = blockIdx.x; F.vcu = (F.G % 8 == 0) ? (bx % 8) * (F.G / 8) + bx / 8 : bx; }
    unsigned char* ws = args.ws;
    F.ctl = (gu32*)(ws + WS_CTL);
    F.x = args.in[0]; F.mem = args.in[1]; F.g_mix = args.in[2]; F.w_in = args.in[3]; F.g_mem = args.in[4]; F.w_mem_kv = args.in[5]; F.w_pool = args.in[6]; F.pool_scale = args.in[7];
    F.w_out = args.in[8]; F.g_ffn = args.in[9]; F.w_ff1 = args.in[10]; F.w_ff2 = args.in[11]; F.g_final = args.in[12]; F.out = args.out;
    F.Win_t = (bf16*)(ws + WS_WIN); F.Wo_t = (bf16*)(ws + WS_WO); F.W1_t = (bf16*)(ws + WS_W1); F.W2_t = (bf16*)(ws + WS_W2); F.Wmk_t = (bf16*)(ws + WS_WMK); F.WpT = (bf16*)(ws + WS_WPT);
    F.KM = (bf16*)(ws + WS_KM); F.VM = (bf16*)(ws + WS_VM); F.MN = (bf16*)(ws + WS_MN); F.XB = (bf16*)(ws + WS_XB); F.HB = (bf16*)(ws + WS_H);
    F.PROJ = (bf16*)(ws + WS_PROJ); F.XN = (bf16*)(ws + WS_XN); F.Y = (bf16*)(ws + WS_Y); F.SS = (float*)(ws + WS_SS); F.SS2 = (float*)(ws + WS_SS2);
    for (int u = F.tid; u < (LDS_BYTES - LDSCTL_OFF) / 4; u += NWAVES * 64) ((LAS unsigned*)(F.lds + LDSCTL_OFF))[u] = 0u;
    __syncthreads();
    XcdBarrier bar = xcd_barrier_post((unsigned*)(F.ctl + CW_BAR), F.MISC + 8);
#define GRID_BAR() xcd_barrier(bar)
    const int lo = args.ph_lo, hi = args.ph_hi;
#define IN(k) (lo <= (k) && (k) < hi)
#ifndef MK_REP
#define MK_REP -1
#endif
#define REPS(k) for (int rep_ = 0; rep_ < ((MK_REP) == (k) ? 2 : 1); ++rep_)
#define REPBAR(k) do { if ((MK_REP) == (k) && rep_ == 0) GRID_BAR(); } while (0)
#define BOTH(k) (IN(k) && IN((k) + 1))

    if (IN(0)) { REPS(0) { p0_prologue(F); REPBAR(0); } if (BOTH(0)) GRID_BAR(); }

    if (IN(1)) { {
        p1_memkv(F);
        pg8::Gemm g{F.XN, F.Win_t, M, NPROJ, D}; pg8::StaticOrder S; S.init(M, NPROJ, F.G, (int)blockIdx.x);
        pg8::EpiProj E{F.PROJ, NPROJ, (1u << 0) | (1u << 1) | (1u << 7), C2};
#if MK_REP == 1
        DoubleOrder S2{S, 4}; pg8::gemm_phase<pg8::EpiProj, DoubleOrder, true, true>(F.lds + RING_OFF, g, S2, E);
#else
        pg8::gemm_phase<pg8::EpiProj, pg8::StaticOrder, true, true>(F.lds + RING_OFF, g, S, E);
#endif
        }
        if (BOTH(1)) GRID_BAR();
    }

    if (IN(2)) { REPS(2) {
#if MK_P2_NAIVE
        p2_naive(F);
#else
        p2_mixer(F);
#endif
        REPBAR(2); }
        if (BOTH(2)) GRID_BAR();
    }

    if (IN(3)) { REPS(3) {
        pg8::Gemm g{F.Y, F.Wo_t, M, D, D}; pg8::StaticOrder S; S.init(M, D, F.G, (int)blockIdx.x);
        pg8::EpiResSS E{F.x, F.XB, F.SS, D};
        pg8::gemm_phase<pg8::EpiResSS, pg8::StaticOrder, true, true>(F.lds + RING_OFF, g, S, E);
        REPBAR(3); }
        if (BOTH(3)) GRID_BAR();
    }

    if (IN(4)) { {
        pg8::Gemm g{F.XB, F.W1_t, M, FF, D}; pg8::StaticOrder S; S.init(M, FF, F.G, (int)blockIdx.x);
        pg8::EpiRelu2 E{F.HB, FF};
#if MK_REP == 4
        DoubleOrder S2{S, 8}; pg8::gemm_phase<pg8::EpiRelu2, DoubleOrder, true, true>(F.lds + RING_OFF, g, S2, E);
#else
        pg8::gemm_phase<pg8::EpiRelu2, pg8::StaticOrder, true, true>(F.lds + RING_OFF, g, S, E);
#endif
        }
        if (BOTH(4)) GRID_BAR();
    }

    if (IN(5)) {
        pg8::Gemm g{F.HB, F.W2_t, M, D, FF}; pg8::StaticOrder S; S.init(M, D, F.G, (int)blockIdx.x);
        pg8::EpiRes2 E{F.XB, F.SS, F.SS2, D, 1.0f / D, RMS_EPS};
        pg8::gemm_phase<pg8::EpiRes2, pg8::StaticOrder, true, true>(F.lds + RING_OFF, g, S, E);
        if (BOTH(5)) GRID_BAR();
    }

    if (IN(6)) {
        const int gw = F.vcu * NWAVES + F.wave, NGW = F.G * NWAVES;
        f32x4 gv[4];
#pragma unroll
        for (int j = 0; j < 4; ++j) gv[j] = ((const GAS f32x4*)F.g_final)[F.lane + 64 * j];
        for (int m = gw; m < M; m += NGW) {
            const GAS f32x4* sp = (const GAS f32x4*)(F.SS2 + (size_t)m * 16);
            const f32x4 a = sp[0], b = sp[1], c = sp[2], d = sp[3];
            const float t = ((a[0] + a[1]) + (a[2] + a[3])) + ((b[0] + b[1]) + (b[2] + b[3])) + ((c[0] + c[1]) + (c[2] + c[3])) + ((d[0] + d[1]) + (d[2] + d[3]));
            const float ri = 1.0f / sqrtf(t * (1.0f / D) + RMS_EPS);
            const GAS unsigned long long* xr = (const GAS unsigned long long*)(F.XB + (size_t)m * D) + F.lane;
            GAS f32x4* orow = (GAS f32x4*)(F.out + (size_t)m * D) + F.lane;
            unsigned long long xv[4];
#pragma unroll
            for (int j = 0; j < 4; ++j) xv[j] = xr[64 * j];
#pragma unroll
            for (int j = 0; j < 4; ++j) { const unsigned lo = (unsigned)xv[j], hv = (unsigned)(xv[j] >> 32);
                f32x4 o; o.x = __uint_as_float(lo << 16) * ri * gv[j].x; o.y = __uint_as_float(lo & 0xffff0000u) * ri * gv[j].y; o.z = __uint_as_float(hv << 16) * ri * gv[j].z; o.w = __uint_as_float(hv & 0xffff0000u) * ri * gv[j].w;
                orow[64 * j] = o; }
        }
    }
#undef IN
#undef BOTH
}

extern "C" void kernel_launch(void* const* d_in, const int* in_sizes, int n_in, void* d_out, int out_size, void* d_ws, size_t ws_size, hipStream_t stream) {
    static int grid = 0;
    if (grid == 0) {
        if (n_in != 13 || in_sizes[0] != M * D || out_size != M * D || ws_size < WS_END) { fprintf(stderr, "kernel_launch: unexpected shapes: n_in %d in0 %d out %d ws %zu; nothing launched\n", n_in, n_in > 0 ? in_sizes[0] : -1, out_size, ws_size); grid = -1; return; }
        int dev = 0, cus = 0, per_cu = 0;
        if (hipGetDevice(&dev) != hipSuccess || hipDeviceGetAttribute(&cus, hipDeviceAttributeMultiprocessorCount, dev) != hipSuccess) { fprintf(stderr, "kernel_launch: device query failed\n"); grid = -1; return; }
        if (hipFuncSetAttribute((const void*)hymba_fwd, hipFuncAttributeMaxDynamicSharedMemorySize, LDS_BYTES) != hipSuccess) { fprintf(stderr, "kernel_launch: hipFuncSetAttribute failed\n"); grid = -1; return; }
        if (hipOccupancyMaxActiveBlocksPerMultiprocessor(&per_cu, (const void*)hymba_fwd, NWAVES * 64, LDS_BYTES) != hipSuccess || per_cu < 1)
            fprintf(stderr, "kernel_launch: note: occupancy query reports %d workgroups per CU\n", per_cu);
        (void)hipGetLastError();
        grid = cus;
        if (grid != 256) fprintf(stderr, "kernel_launch: %d CUs; the fused final RMSNorm expects 256\n", grid);
    }
    if (grid < 0) return;
    if (hipMemsetAsync((char*)d_ws + WS_CTL, 0, CTL_ZERO_BYTES, stream) != hipSuccess) { fprintf(stderr, "kernel_launch: hipMemsetAsync failed\n"); return; }
    Args a{};
    for (int i = 0; i < 13; ++i) a.in[i] = (const float*)d_in[i];
    a.out = (float*)d_out; a.ws = (unsigned char*)d_ws; a.ph_lo = 0; a.ph_hi = 7;
    hipLaunchKernelGGL(hymba_fwd, dim3(grid), dim3(NWAVES * 64), LDS_BYTES, stream, a);
    const hipError_t le = hipPeekAtLastError();
    if (le != hipSuccess) fprintf(stderr, "kernel_launch: launch failed: %s\n", hipGetErrorName(le));
}
```
